# Optimizing an MI355X kernel written in HIP

```python
import math
import jax, jax.numpy as jnp
from jax import lax
import numpy as np

D_MODEL = 1024
BATCH = 8
SEQ = 2048
DEPTH = 1
DEC_BATCH = 128
DEC_SEQ = 1
PAST_LEN = 16384
PAGE_SIZE = 128

P_DIM = 256
M_HEADS = 4
M_WIDTH = D_MODEL
M_HEAD_DIM = M_WIDTH // M_HEADS
C_WIDTH = D_MODEL
CONV_W = 3
D_FF = (11 * D_MODEL) // 4
CHUNK = 64
LN_EPS = 1e-5
ALPHA = (2 * DEPTH) ** 0.25
BETA = (8 * DEPTH) ** -0.25
F_BIAS_LO = 3.0
F_BIAS_HI = 6.0

Q0 = 0
K0 = Q0 + M_WIDTH
V0 = K0 + M_WIDTH
O0 = V0 + M_WIDTH
I0 = O0 + M_WIDTH
F0 = I0 + M_HEADS
CB0 = F0 + M_HEADS
CC0 = CB0 + C_WIDTH
CH0 = CC0 + C_WIDTH
GA0 = CH0 + C_WIDTH
GB0 = GA0 + D_MODEL
N_IN = GB0 + D_MODEL

kernel_name = "hybrid_mlstm_shortconv_deepnorm_step"


def layer_norm(x, g, b):
    x32 = x.astype(jnp.float32)
    mu = x32.mean(-1, keepdims=True)
    var = jnp.square(x32 - mu).mean(-1, keepdims=True)
    out = (x32 - mu) * lax.rsqrt(var + LN_EPS) * g.astype(jnp.float32) + b.astype(jnp.float32)
    return out.astype(x.dtype)


def head_norm(h, g):
    mu = h.mean(-1, keepdims=True)
    var = jnp.square(h - mu).mean(-1, keepdims=True)
    return (h - mu) * lax.rsqrt(var + LN_EPS) * g.astype(jnp.float32)


def swiglu(x, wi, wo):
    g, u = jnp.split(x @ wi, 2, axis=-1)
    return (jax.nn.silu(g) * u) @ wo


def mlstm_chunkwise(q, k, v, log_i, log_f, C0, n0, m0):
    B, L, H, Dh = q.shape
    lc = math.gcd(L, CHUNK)
    nc = L // lc

    def to_chunks(a):
        a = a.reshape((B, nc, lc, H) + a.shape[3:])
        return jnp.moveaxis(a, (1, 3), (0, 2))

    tril = jnp.tril(jnp.ones((lc, lc), dtype=bool))

    def body(carry, inp):
        C, n, m = carry
        qc, kc, vc, li, lf = inp
        b = jnp.cumsum(lf, axis=-1)
        dmat = b[..., :, None] - b[..., None, :] + li[..., None, :]
        dmat = jnp.where(tril, dmat, float('-inf'))
        inter = b + m[..., None]
        m_row = jnp.maximum(inter, dmat.max(-1))
        w_inter = jnp.exp(inter - m_row)
        s = jnp.einsum('bhtd,bhsd->bhts', qc, kc) * jnp.exp(dmat - m_row[..., None])
        num = (w_inter[..., None] * jnp.einsum('bhtd,bhde->bhte', qc, C)
               + jnp.einsum('bhts,bhse->bhte', s, vc))
        den = w_inter * jnp.einsum('bhtd,bhd->bht', qc, n) + s.sum(-1)
        h = num / jnp.maximum(jnp.abs(den), jnp.exp(-m_row))[..., None]
        b_end = b[..., -1]
        dec = b_end[..., None] - b + li
        m_new = jnp.maximum(b_end + m, dec.max(-1))
        w_c = jnp.exp(b_end + m - m_new)
        kw = kc * jnp.exp(dec - m_new[..., None])[..., None]
        C_new = w_c[..., None, None] * C + jnp.einsum('bhsd,bhse->bhde', kw, vc)
        n_new = w_c[..., None] * n + kw.sum(-2)
        return (C_new, n_new, m_new), h

    init = (C0.astype(jnp.float32), n0.astype(jnp.float32), m0.astype(jnp.float32))
    (C, n, m), h = lax.scan(body, init, (to_chunks(q), to_chunks(k), to_chunks(v),
                                         to_chunks(log_i), to_chunks(log_f)))
    h = jnp.moveaxis(h, (0, 2), (1, 3)).reshape(B, L, H, Dh)
    return h, C, n, m


def short_conv(pre, buf, w, b):
    L = pre.shape[1]
    full = jnp.concatenate([buf.astype(pre.dtype), pre], axis=1)
    y = b
    for j in range(CONV_W):
        y = y + full[:, j:j + L] * w[j]
    return y, full[:, L:]


def decoder_layer(x, p, C0, n0, m0, conv_buf, w_in, b_in, m_norm_g, w_a, w_b, conv_w, conv_b,
                  w_mix, ffn1_wi, ffn1_wo, ffn2_wi, ffn2_wo, w_pg, w_pp, ln_g, ln_b):
    Bn, L, _ = x.shape
    f32 = jnp.float32
    x = layer_norm(ALPHA * x + 0.5 * swiglu(x, ffn1_wi, ffn1_wo), ln_g[0], ln_b[0])
    z = x @ w_in + b_in
    hs = (Bn, L, M_HEADS, M_HEAD_DIM)
    q = z[..., Q0:K0].reshape(hs).astype(f32)
    k = z[..., K0:V0].reshape(hs).astype(f32) * (M_HEAD_DIM ** -0.5)
    v = z[..., V0:O0].reshape(hs).astype(f32)
    log_i = z[..., I0:F0].astype(f32)
    log_f = jax.nn.log_sigmoid(z[..., F0:CB0].astype(f32))
    h, C, n, m = mlstm_chunkwise(q, k, v, log_i, log_f, C0, n0, m0)
    hn = head_norm(h, m_norm_g).reshape(Bn, L, M_WIDTH).astype(x.dtype)
    y_a = (hn * jax.nn.sigmoid(z[..., O0:I0])) @ w_a
    pre = z[..., CC0:CH0] * z[..., CH0:GA0]
    conv, new_buf = short_conv(pre, conv_buf, conv_w, conv_b)
    y_b = (z[..., CB0:CC0] * conv) @ w_b
    mix = (jax.nn.sigmoid(z[..., GA0:GB0]) * y_a + jax.nn.sigmoid(z[..., GB0:N_IN]) * y_b) @ w_mix
    x = layer_norm(ALPHA * x + mix, ln_g[1], ln_b[1])
    x = layer_norm(ALPHA * x + 0.5 * swiglu(x, ffn2_wi, ffn2_wo), ln_g[2], ln_b[2])
    x = layer_norm(ALPHA * x + jax.nn.sigmoid(x @ w_pg) * (p @ w_pp), ln_g[3], ln_b[3])
    return x, C, n, m, new_buf


def setup_inputs(seed: int = 0) -> dict:
    key = jax.random.key(seed)
    ks = jax.random.split(key, 32)

    def nrm(k, shape, scale):
        return jax.random.normal(k, shape, jnp.float32) * scale

    b_in = nrm(ks[10], (DEPTH, N_IN), 0.02)
    f_bias = jnp.linspace(F_BIAS_LO, F_BIAS_HI, M_HEADS, dtype=jnp.float32)[None, :] + nrm(ks[11], (DEPTH, M_HEADS), 0.1)
    b_in = b_in.at[:, F0:CB0].set(f_bias)
    return {
        "x_prompt": nrm(ks[0], (BATCH, SEQ, D_MODEL), 1.0),
        "x_sample": nrm(ks[1], (DEC_BATCH, DEC_SEQ, D_MODEL), 1.0),
        "p_prompt": nrm(ks[2], (DEPTH, BATCH, SEQ, P_DIM), 1.0),
        "p_sample": nrm(ks[3], (DEPTH, DEC_BATCH, DEC_SEQ, P_DIM), 1.0),
        "state_C": nrm(ks[4], (DEPTH, DEC_BATCH, M_HEADS, M_HEAD_DIM, M_HEAD_DIM), M_HEAD_DIM ** -0.5),
        "state_n": nrm(ks[5], (DEPTH, DEC_BATCH, M_HEADS, M_HEAD_DIM), M_HEAD_DIM ** -0.5),
        "state_m": nrm(ks[6], (DEPTH, DEC_BATCH, M_HEADS), 1.0),
        "state_conv": nrm(ks[7], (DEPTH, DEC_BATCH, CONV_W - 1, C_WIDTH), 1.0),
        "w_in": nrm(ks[8], (DEPTH, D_MODEL, N_IN), D_MODEL ** -0.5),
        "b_in": b_in,
        "m_norm_g": 1.0 + nrm(ks[12], (DEPTH, M_HEADS, M_HEAD_DIM), 0.02),
        "w_a": nrm(ks[13], (DEPTH, M_WIDTH, D_MODEL), M_WIDTH ** -0.5),
        "w_b": nrm(ks[14], (DEPTH, C_WIDTH, D_MODEL), C_WIDTH ** -0.5),
        "conv_w": nrm(ks[15], (DEPTH, CONV_W, C_WIDTH), CONV_W ** -0.5),
        "conv_b": nrm(ks[16], (DEPTH, C_WIDTH), 0.02),
        "w_mix": nrm(ks[17], (DEPTH, D_MODEL, D_MODEL), BETA * D_MODEL ** -0.5),
        "ffn1_wi": nrm(ks[18], (DEPTH, D_MODEL, 2 * D_FF), D_MODEL ** -0.5),
        "ffn1_wo": nrm(ks[19], (DEPTH, D_FF, D_MODEL), BETA * D_FF ** -0.5),
        "ffn2_wi": nrm(ks[20], (DEPTH, D_MODEL, 2 * D_FF), D_MODEL ** -0.5),
        "ffn2_wo": nrm(ks[21], (DEPTH, D_FF, D_MODEL), BETA * D_FF ** -0.5),
        "w_pg": nrm(ks[22], (DEPTH, D_MODEL, D_MODEL), D_MODEL ** -0.5),
        "w_pp": nrm(ks[23], (DEPTH, P_DIM, D_MODEL), BETA * P_DIM ** -0.5),
        "ln_g": 1.0 + nrm(ks[24], (DEPTH, 4, D_MODEL), 0.02),
        "ln_b": nrm(ks[25], (DEPTH, 4, D_MODEL), 0.02),
    }


def reference(x_prompt, x_sample, p_prompt, p_sample, state_C, state_n, state_m, state_conv,
              w_in, b_in, m_norm_g, w_a, w_b, conv_w, conv_b, w_mix,
              ffn1_wi, ffn1_wo, ffn2_wi, ffn2_wo, w_pg, w_pp, ln_g, ln_b):
    xp, xs = x_prompt, x_sample
    nb = x_prompt.shape[0]
    Cp_l, np_l, mp_l, bp_l = [], [], [], []
    Cs_l, ns_l, ms_l, bs_l = [], [], [], []
    for i in range(DEPTH):
        wl = (w_in[i], b_in[i], m_norm_g[i], w_a[i], w_b[i], conv_w[i], conv_b[i], w_mix[i],
              ffn1_wi[i], ffn1_wo[i], ffn2_wi[i], ffn2_wo[i], w_pg[i], w_pp[i], ln_g[i], ln_b[i])
        C0 = jnp.zeros((nb, M_HEADS, M_HEAD_DIM, M_HEAD_DIM), jnp.float32)
        n0 = jnp.zeros((nb, M_HEADS, M_HEAD_DIM), jnp.float32)
        m0 = jnp.zeros((nb, M_HEADS), jnp.float32)
        buf0 = jnp.zeros((nb, CONV_W - 1, C_WIDTH), xp.dtype)
        xp, Cp, np_, mp, bp = decoder_layer(xp, p_prompt[i], C0, n0, m0, buf0, *wl)
        xs, Cs, ns, ms, bs = decoder_layer(xs, p_sample[i], state_C[i], state_n[i], state_m[i],
                                           state_conv[i], *wl)
        Cp_l.append(Cp); np_l.append(np_); mp_l.append(mp); bp_l.append(bp)
        Cs_l.append(Cs); ns_l.append(ns); ms_l.append(ms); bs_l.append(bs)
    C_prompt = jnp.stack(Cp_l)
    n_prompt = jnp.stack(np_l)
    m_prompt = jnp.stack(mp_l)
    conv_prompt = jnp.stack(bp_l)
    C_sample = jnp.stack(Cs_l)
    n_sample = jnp.stack(ns_l)
    m_sample = jnp.stack(ms_l)
    conv_sample = jnp.stack(bs_l)
    return (xp, xs, C_prompt, n_prompt, m_prompt, conv_prompt, C_sample, n_sample, m_sample, conv_sample)
```

```cpp
#include <hip/hip_runtime.h>
#include <cstdio>
#include <cstdint>
constexpr int D = 1024, NB = 8, SEQ = 2048, T_PROMPT = NB * SEQ, T_SAMPLE = 128, M_REAL = T_PROMPT + T_SAMPLE, M_PAD = 16640;
constexpr int FF = 2816, NIN = 9224, NZ = 9216, PD = 256, NH = 4, HD = 256, CHUNK = 64, NCHUNK = SEQ / CHUNK;
constexpr float ALPHA = 1.189207115002721f, LN_EPS = 1e-5f;
constexpr int I0_COL = 4096;
constexpr size_t MiB = 1u << 20;
constexpr size_t WS_CTL = 0, CTL_ZERO_BYTES = 1 * MiB;
constexpr size_t WS_BPERM = 1 * MiB;
constexpr size_t WS_WG = 1 * MiB + 65536;
constexpr size_t WS_BG = WS_WG + 8 * 1024 * 4;
constexpr size_t WS_GATES = 2 * MiB;
constexpr size_t WS_WI1 = 4 * MiB, WS_WO1 = 15 * MiB, WS_WIN = 20 * MiB + 512 * 1024, WS_WA = 38 * MiB + 512 * 1024, WS_WB = WS_WA + 2 * MiB, WS_WMIX = WS_WB + 2 * MiB,
                 WS_WPG = WS_WMIX + 2 * MiB, WS_WPP = WS_WPG + 2 * MiB, WS_WI2 = 47 * MiB, WS_WO2 = 58 * MiB;
constexpr size_t WS_PB = 64 * MiB;
constexpr size_t WS_SLAB0 = 73 * MiB, SLABB = (size_t)M_PAD * D * 2;
constexpr size_t WS_END = WS_SLAB0 + 13 * SLABB;
static_assert(WS_WO2 + (size_t)D * FF * 2 <= WS_PB && WS_PB + (size_t)M_PAD * PD * 2 <= WS_SLAB0 && WS_END <= 512 * MiB, "d_ws map");
static_assert(WS_WI1 + (size_t)2 * FF * D * 2 <= WS_WO1 && WS_WO1 + (size_t)D * FF * 2 <= WS_WIN && WS_WIN + (size_t)NZ * D * 2 <= WS_WA && WS_WPP + (size_t)D * PD * 2 <= WS_WI2 && WS_WI2 + (size_t)2 * FF * D * 2 <= WS_WO2, "weights map");
enum { SL_X = 0, SL_H = 1, SL_Q = 1, SL_K = 2, SL_V = 3, SL_AA = 1, SL_AB = 2, SL_MIX = 3, SL_O = 4, SL_X2 = 4, SL_BB = 5, SL_PP = 5, SL_PRE = 6, SL_TA = 6, SL_SGA = 7, SL_SGB = 8, SL_HRAW = 9, SL_R = 11 };
constexpr size_t O_YP = 0, O_YS = 16777216, O_CP = 16908288, O_NP = 19005440, O_MP = 19013632, O_CVP = 19013664, O_CS = 19030048, O_NS = 52584480, O_MS = 52715552, O_CVS = 52716064, O_TOTAL = 52978208;
constexpr int CW_TMO = 0, CW_CODE = 1, CW_BAR = 4096;
namespace pg8 {
#define PG8_LAS __attribute__((address_space(3)))
typedef unsigned short bf16_t;
typedef short bf16x8 __attribute__((ext_vector_type(8)));
typedef float f32x4 __attribute__((ext_vector_type(4)));
typedef unsigned u32x4 __attribute__((ext_vector_type(4)));
constexpr int BM = 256, BK = 64, HALF = 128, HTB = HALF * BK * 2  , STAGE_BYTES = 8 * HTB, NXCD = 8, WGM = 8;

__host__ __device__ __forceinline__ int lds_byte(int r, int c) { const int st = (r >> 4) * 2 + (c >> 5), rr = r & 15, cc = c & 31, ob = rr * 64 + cc * 2; return st * 1024 + (ob ^ (((ob >> 9) & 1) << 5)); }
__host__ __device__ __forceinline__ void stage_rc(int b, int& R, int& C) { const int st = b / 1024, sb = b % 1024, swz = sb ^ (((sb >> 9) & 1) << 5); R = (st >> 1) * 16 + swz / 64; C = (st & 1) * 32 + (swz % 64) / 2; }
__host__ __device__ __forceinline__ int perm32(int rho) { const int n = rho >> 4, i = rho & 15; return 8 * (i >> 2) + 4 * n + (i & 3); }

struct Unit { int pm, pn; };
struct Gemm { const bf16_t* A; const bf16_t* Bt; int M, N, K; };

struct StaticOrder {
    int nM, nN, nwg, G, c;
    __host__ __device__ void init(int M, int N, int G_, int c_) { nM = M / BM; nN = N / BM; nwg = nM * nN; G = G_; c = c_; }
    __host__ __device__ bool next(int i, Unit& u) const {
        const long L = (long)i * G + c; if (L >= nwg) return false;
        int wgid = (int)L; { const int q = nwg / NXCD, r = nwg % NXCD, xcd = wgid % NXCD, off = wgid / NXCD; wgid = (xcd < r ? xcd * (q + 1) : r * (q + 1) + (xcd - r) * q) + off; }
        const int nig = WGM * nN, gid = wgid / nig, fm = gid * WGM, gsz = (nM - fm) < WGM ? (nM - fm) : WGM;
        u.pm = fm + ((wgid % nig) % gsz); u.pn = (wgid % nig) / gsz; return true;
    }
    __device__ __forceinline__ void a_ready(const Unit&) const {}
    __device__ __forceinline__ void done(const Unit&) const {}
};

__device__ __forceinline__ unsigned cvt_pk_bf16(float lo, float hi) { unsigned r; asm volatile("v_cvt_pk_bf16_f32 %0, %1, %2" : "=v"(r) : "v"(lo), "v"(hi)); return r; }
__device__ __forceinline__ float fsigmoid(float x) { return __builtin_amdgcn_rcpf(1.0f + __builtin_amdgcn_exp2f(-1.4426950408889634f * x)); }
__device__ __forceinline__ float bf_lo(unsigned w) { return __uint_as_float(w << 16); }
__device__ __forceinline__ float bf_hi(unsigned w) { return __uint_as_float(w & 0xffff0000u); }
typedef unsigned u32x2 __attribute__((ext_vector_type(2)));
__device__ __forceinline__ u32x4 pack8(const f32x4 a, const f32x4 b) { u32x4 w; w.x = cvt_pk_bf16(a[0], a[1]); w.y = cvt_pk_bf16(a[2], a[3]); w.z = cvt_pk_bf16(b[0], b[1]); w.w = cvt_pk_bf16(b[2], b[3]); return w; }
__device__ __forceinline__ void unpack8(const u32x4 w, f32x4& a, f32x4& b) { a = (f32x4){bf_lo(w.x), bf_hi(w.x), bf_lo(w.y), bf_hi(w.y)}; b = (f32x4){bf_lo(w.z), bf_hi(w.z), bf_lo(w.w), bf_hi(w.w)}; }
__device__ __forceinline__ f32x4 unpack4(const u32x2 w) { return (f32x4){bf_lo(w.x), bf_hi(w.x), bf_lo(w.y), bf_hi(w.y)}; }
__device__ __forceinline__ f32x4 sig4(const f32x4 v) { return (f32x4){fsigmoid(v[0]), fsigmoid(v[1]), fsigmoid(v[2]), fsigmoid(v[3])}; }

enum { EB_SWIGLU = 0, EB_WIN = 1, EB_GATE_A = 2, EB_GATE_B = 3, EB_PLAIN = 4 };
struct EpiBf {
    static constexpr bool PERM = true, AFTER_DRAIN = false;
    int mode; bf16_t* O; int ldo; const bf16_t* G; const bf16_t* T; const float* bias; unsigned char* slabs;
    __device__ __forceinline__ void operator()(const f32x4 (&acc)[2][2][4][2], const Unit& u, int wr, int wc, int fr, int fq) const {
        const int row0 = u.pm * BM + wr * 64 + fr;
        if (mode == EB_SWIGLU) {
            const int col0 = u.pn * 128 + wc * 32 + 8 * fq;
#pragma unroll
            for (int ai = 0; ai < 2; ++ai)
#pragma unroll
                for (int m = 0; m < 4; ++m) {
                    const f32x4 g0 = acc[ai][0][m][0], g1 = acc[ai][0][m][1], u0 = acc[ai][1][m][0], u1 = acc[ai][1][m][1];
                    const f32x4 o0 = g0 * sig4(g0) * u0, o1 = g1 * sig4(g1) * u1;
                    *(u32x4*)(O + (size_t)(row0 + ai * HALF + m * 16) * ldo + col0) = pack8(o0, o1);
                }
        } else if (mode == EB_WIN) {
            const int pn = u.pn; int kind, slab, colbase;
            if (pn < 20) { const int gi = pn >> 2; slab = 1 + gi; colbase = (pn & 3) * 256; kind = (gi == 3) ? 1 : 0; }
            else if (pn < 28) { slab = 6; colbase = (pn - 20) * 128; kind = 2; }
            else { slab = 7 + ((pn - 28) >> 2); colbase = ((pn - 28) & 3) * 256; kind = 1; }
            bf16_t* base = (bf16_t*)(slabs + (size_t)slab * SLABB) + colbase + wc * 32 + 8 * fq;
            const int bc0 = pn * 256 + wc * 32 + 8 * fq;
            f32x4 bv[2][2];
#pragma unroll
            for (int bj = 0; bj < 2; ++bj)
#pragma unroll
                for (int n = 0; n < 2; ++n) bv[bj][n] = *(const f32x4*)(bias + bc0 + bj * HALF + 4 * n);
            if (kind == 2) {
#pragma unroll
                for (int ai = 0; ai < 2; ++ai)
#pragma unroll
                    for (int m = 0; m < 4; ++m) {
                        const f32x4 o0 = (acc[ai][0][m][0] + bv[0][0]) * (acc[ai][1][m][0] + bv[1][0]), o1 = (acc[ai][0][m][1] + bv[0][1]) * (acc[ai][1][m][1] + bv[1][1]);
                        *(u32x4*)(base + (size_t)(row0 + ai * HALF + m * 16) * D) = pack8(o0, o1);
                    }
            } else {
#pragma unroll
                for (int ai = 0; ai < 2; ++ai)
#pragma unroll
                    for (int m = 0; m < 4; ++m)
#pragma unroll
                        for (int bj = 0; bj < 2; ++bj) {
                            f32x4 o0 = acc[ai][bj][m][0] + bv[bj][0], o1 = acc[ai][bj][m][1] + bv[bj][1];
                            if (kind == 1) { o0 = sig4(o0); o1 = sig4(o1); }
                            *(u32x4*)(base + (size_t)(row0 + ai * HALF + m * 16) * D + bj * HALF) = pack8(o0, o1);
                        }
            }
        } else {
            const int col0 = u.pn * BM + wc * 32 + 8 * fq;
#pragma unroll
            for (int ai = 0; ai < 2; ++ai)
#pragma unroll
                for (int m = 0; m < 4; ++m) {
#pragma unroll
                    for (int bj = 0; bj < 2; ++bj) {
                        const size_t off = (size_t)(row0 + ai * HALF + m * 16) * ldo + col0 + bj * HALF;
                        f32x4 o0 = acc[ai][bj][m][0], o1 = acc[ai][bj][m][1];
                        if (mode == EB_GATE_A || mode == EB_GATE_B) { f32x4 g0, g1; unpack8(*(const u32x4*)(G + off), g0, g1); o0 = o0 * g0; o1 = o1 * g1; }
                        if (mode == EB_GATE_B) { f32x4 t0, t1; unpack8(*(const u32x4*)(T + off), t0, t1); o0 = o0 + t0; o1 = o1 + t1; }
                        *(u32x4*)(O + off) = pack8(o0, o1);
                    }
                    asm volatile("" ::: "memory");
                }
        }
    }
};

enum { EF_X = 0, EF_BF = 1, EF_PG = 2, EF_PLAINBF = 3 };
struct EpiF {
    static constexpr bool PERM = false, AFTER_DRAIN = false;
    int mode; float* R; const float* xp; const float* xs; const bf16_t* res; const bf16_t* pp; float scale;
    __device__ __forceinline__ void operator()(const f32x4 (&acc)[2][2][4][2], const Unit& u, int wr, int wc, int fr, int fq) const {
        const int row0 = u.pm * BM + wr * 64 + fr, col0 = u.pn * BM + wc * 32 + 4 * fq;
#pragma unroll
        for (int ai = 0; ai < 2; ++ai)
#pragma unroll
            for (int m = 0; m < 4; ++m) {
                const int row = row0 + ai * HALF + m * 16;
#pragma unroll
                for (int bj = 0; bj < 2; ++bj)
#pragma unroll
                    for (int n = 0; n < 2; ++n) {
                        const int c = col0 + bj * HALF + n * 16; const size_t off = (size_t)row * D + c;
                        const f32x4 a = acc[ai][bj][m][n]; f32x4 o;
                        if (mode == EF_PLAINBF) { u32x2 w; w.x = cvt_pk_bf16(a[0], a[1]); w.y = cvt_pk_bf16(a[2], a[3]); *(u32x2*)((bf16_t*)R + off) = w; continue; }
                        if (mode == EF_X) {
                            f32x4 rv = (f32x4){0.f, 0.f, 0.f, 0.f};
                            if (row < T_PROMPT) rv = *(const f32x4*)(xp + off); else if (row < M_REAL) rv = *(const f32x4*)(xs + (size_t)(row - T_PROMPT) * D + c);
                            o = rv * ALPHA + a * 0.5f;
                        } else {
                            const f32x4 rv = unpack4(*(const u32x2*)(res + off));
                            if (mode == EF_BF) o = rv * ALPHA + a * scale;
                            else { const f32x4 pv = unpack4(*(const u32x2*)(pp + off)); o = rv * ALPHA + sig4(a) * pv; }
                        }
                        *(f32x4*)(R + off) = o;
                    }
                asm volatile("" ::: "memory");
            }
    }
};

template <class Epi, class Sched, bool ALIGN_EPI = false, bool SP2 = false>
__device__ __forceinline__ void gemm_phase(PG8_LAS unsigned char* lds, const Gemm g, const Sched& S, const Epi& E) {
    const int tid = threadIdx.x, wid = __builtin_amdgcn_readfirstlane(tid >> 6), lane = tid & 63, wr = wid >> 2, wc = wid & 3, fr = lane & 15, fq = lane >> 4;
    const int K = g.K, nt = K / BK;
    unsigned voffA[2], voffB[2];
#pragma unroll
    for (int i = 0; i < 2; ++i) { int R, C; stage_rc(tid * 16 + i * 8192, R, C); const int Rb = Epi::PERM ? ((R & ~31) + perm32(R & 31)) : R;
        voffA[i] = (unsigned)(R * K + C) * 2u; voffB[i] = (unsigned)(Rb * K + C) * 2u; }
    const size_t kstep = (size_t)(BK * 2);
    const size_t hstep = (size_t)HALF * K * 2;
    const size_t tstep = 2 * hstep;
    const unsigned ldsw = (unsigned)wid * 1024u;
    const int aoff = lds_byte(wr * 64 + fr, fq * 8), boff = lds_byte(wc * 32 + fr, fq * 8);
#define PG8_SA(b, h) (((b) * 2 + (h)) * HTB)
#define PG8_SB(b, h) ((4 + (b) * 2 + (h)) * HTB)
#define PG8_STAGE(bufoff, gbase, voff) do { _Pragma("unroll") for (int _i = 0; _i < 2; ++_i) \
        __builtin_amdgcn_global_load_lds((const unsigned*)((const char*)(gbase) + (voff)[_i]), (PG8_LAS unsigned*)(lds + (bufoff) + ldsw + _i * 8192), 16, 0, 0); } while (0)
#define PG8_LDA(dst, b, h) do { _Pragma("unroll") for (int m = 0; m < 4; ++m) _Pragma("unroll") for (int k = 0; k < 2; ++k) dst[m][k] = *(const PG8_LAS bf16x8*)(lds + PG8_SA(b, h) + aoff + m * 2048 + k * 1024); } while (0)
#define PG8_LDB(dst, b, h) do { _Pragma("unroll") for (int n = 0; n < 2; ++n) _Pragma("unroll") for (int k = 0; k < 2; ++k) dst[n][k] = *(const PG8_LAS bf16x8*)(lds + PG8_SB(b, h) + boff + n * 2048 + k * 1024); } while (0)
#define PG8_MMA(ai, bj, At, Bt) do { __builtin_amdgcn_s_setprio(1); _Pragma("unroll") for (int m = 0; m < 4; ++m) _Pragma("unroll") for (int n = 0; n < 2; ++n) _Pragma("unroll") for (int k = 0; k < 2; ++k) \
        acc[ai][bj][m][n] = __builtin_amdgcn_mfma_f32_16x16x32_bf16(Bt[n][k], At[m][k], acc[ai][bj][m][n], 0, 0, 0); __builtin_amdgcn_s_setprio(0); } while (0)
#define PG8_WAIT_V(n) asm volatile("s_waitcnt vmcnt(" #n ")" ::: "memory")
#define PG8_WAIT_L(n) asm volatile("s_waitcnt lgkmcnt(" #n ")" ::: "memory")
#define PG8_BAR __builtin_amdgcn_s_barrier()
#define PG8_SCHED __builtin_amdgcn_sched_barrier(0)
    Unit cur, nxt; int ui = 0;
    if (!S.next(0, cur)) return;
    f32x4 acc[2][2][4][2];
#pragma unroll
    for (int a = 0; a < 2; ++a)
#pragma unroll
        for (int b = 0; b < 2; ++b)
#pragma unroll
            for (int m = 0; m < 4; ++m)
#pragma unroll
                for (int n = 0; n < 2; ++n) acc[a][b][m][n] = (f32x4){0.f, 0.f, 0.f, 0.f};
    bf16x8 At[4][2], B0[2][2], B1[2][2];
    const char* cA = (const char*)g.A + (size_t)cur.pm * tstep; const char* cB = (const char*)g.Bt + (size_t)cur.pn * tstep;
    S.a_ready(cur);
    if constexpr (SP2) {
        PG8_STAGE(PG8_SB(0, 0), cB, voffB); PG8_STAGE(PG8_SB(0, 1), cB + hstep, voffB); PG8_STAGE(PG8_SA(0, 0), cA, voffA); PG8_STAGE(PG8_SA(0, 1), cA + hstep, voffA);
        if (wr == 1) PG8_BAR;
        PG8_WAIT_V(2); PG8_BAR;
        PG8_STAGE(PG8_SB(1, 0), cB + kstep, voffB); PG8_STAGE(PG8_SA(1, 0), cA + kstep, voffA); PG8_STAGE(PG8_SB(1, 1), cB + hstep + kstep, voffB);
        PG8_WAIT_V(6); PG8_BAR;
    } else {
        PG8_STAGE(PG8_SB(0, 0), cB, voffB); PG8_STAGE(PG8_SA(0, 0), cA, voffA); PG8_STAGE(PG8_SB(0, 1), cB + hstep, voffB); PG8_STAGE(PG8_SA(0, 1), cA + hstep, voffA);
        if (wr == 1) PG8_BAR;
        PG8_WAIT_V(4); PG8_BAR;
        PG8_STAGE(PG8_SB(1, 0), cB + kstep, voffB); PG8_STAGE(PG8_SA(1, 0), cA + kstep, voffA); PG8_STAGE(PG8_SB(1, 1), cB + hstep + kstep, voffB);
        PG8_WAIT_V(6); PG8_BAR;
    }
    for (;;) {
        const bool has_next = S.next(ui + 1, nxt);
        const char* nA = has_next ? (const char*)g.A + (size_t)nxt.pm * tstep : cA; const char* nB = has_next ? (const char*)g.Bt + (size_t)nxt.pn * tstep : cB;
        for (int t = 0; t < nt; t += 2) {
            const bool last = (t == nt - 2);
            const char* a1 = cA + (size_t)(t + 1) * kstep;
            const char* a2 = last ? nA : cA + (size_t)(t + 2) * kstep; const char* b2 = last ? nB : cB + (size_t)(t + 2) * kstep;
            const char* a3 = a2 + kstep; const char* b3 = b2 + kstep;
            if (last && has_next) S.a_ready(nxt);
            if constexpr (SP2) {
            PG8_LDB(B0, 0, 0); PG8_LDB(B1, 0, 1); PG8_SCHED; PG8_LDA(At, 0, 0); PG8_STAGE(PG8_SA(1, 1), a1 + hstep, voffA);
            PG8_WAIT_V(8); PG8_WAIT_L(0); PG8_BAR; PG8_MMA(0, 0, At, B0); PG8_MMA(0, 1, At, B1); PG8_BAR; PG8_SCHED;
            PG8_LDA(At, 0, 1); PG8_STAGE(PG8_SB(0, 0), b2, voffB); PG8_STAGE(PG8_SB(0, 1), b2 + hstep, voffB); PG8_STAGE(PG8_SA(0, 0), a2, voffA);
            PG8_WAIT_V(8); PG8_WAIT_L(0); PG8_BAR; PG8_MMA(1, 0, At, B0); PG8_MMA(1, 1, At, B1); PG8_BAR; PG8_SCHED;
            PG8_LDB(B0, 1, 0); PG8_LDB(B1, 1, 1); PG8_SCHED; PG8_LDA(At, 1, 0); PG8_STAGE(PG8_SA(0, 1), a2 + hstep, voffA);
            PG8_WAIT_V(8); PG8_WAIT_L(0); PG8_BAR; PG8_MMA(0, 0, At, B0); PG8_MMA(0, 1, At, B1); PG8_BAR; PG8_SCHED;
            PG8_LDA(At, 1, 1); PG8_STAGE(PG8_SB(1, 0), b3, voffB); PG8_STAGE(PG8_SB(1, 1), b3 + hstep, voffB); PG8_STAGE(PG8_SA(1, 0), a3, voffA);
            PG8_WAIT_V(8); PG8_WAIT_L(0); PG8_BAR; PG8_MMA(1, 0, At, B0); PG8_MMA(1, 1, At, B1); PG8_BAR; PG8_SCHED;
            } else {
            PG8_LDB(B0, 0, 0); PG8_SCHED; PG8_LDA(At, 0, 0); PG8_STAGE(PG8_SA(1, 1), a1 + hstep, voffA);
            PG8_WAIT_L(8); PG8_BAR; PG8_WAIT_L(0); PG8_MMA(0, 0, At, B0); PG8_BAR; PG8_SCHED;
            PG8_LDB(B1, 0, 1); PG8_STAGE(PG8_SB(0, 0), b2, voffB);
            PG8_BAR; PG8_WAIT_L(0); PG8_MMA(0, 1, At, B1); PG8_BAR;
            PG8_LDA(At, 0, 1); PG8_STAGE(PG8_SA(0, 0), a2, voffA);
            PG8_BAR; PG8_WAIT_L(0); PG8_MMA(1, 0, At, B0); PG8_BAR; PG8_SCHED;
            PG8_STAGE(PG8_SB(0, 1), b2 + hstep, voffB);
            PG8_WAIT_V(6); PG8_BAR; PG8_MMA(1, 1, At, B1); PG8_BAR;
            PG8_LDB(B0, 1, 0); PG8_SCHED; PG8_LDA(At, 1, 0); PG8_STAGE(PG8_SA(0, 1), a2 + hstep, voffA);
            PG8_WAIT_L(8); PG8_BAR; PG8_WAIT_L(0); PG8_MMA(0, 0, At, B0); PG8_BAR; PG8_SCHED;
            PG8_LDB(B1, 1, 1); PG8_STAGE(PG8_SB(1, 0), b3, voffB);
            PG8_BAR; PG8_WAIT_L(0); PG8_MMA(0, 1, At, B1); PG8_BAR;
            PG8_LDA(At, 1, 1); PG8_STAGE(PG8_SA(1, 0), a3, voffA);
            PG8_BAR; PG8_WAIT_L(0); PG8_MMA(1, 0, At, B0); PG8_BAR; PG8_SCHED;
            PG8_STAGE(PG8_SB(1, 1), b3 + hstep, voffB);
            PG8_WAIT_V(6); PG8_BAR; PG8_MMA(1, 1, At, B1); PG8_BAR;
            }
        }
        if constexpr (ALIGN_EPI) { if (wr == 0) PG8_BAR; }
        if constexpr (!Epi::AFTER_DRAIN) { E(acc, cur, wr, wc, fr, fq); S.done(cur); }
        if (!has_next) break;
#pragma unroll
        for (int a = 0; a < 2; ++a)
#pragma unroll
            for (int b = 0; b < 2; ++b)
#pragma unroll
                for (int m = 0; m < 4; ++m)
#pragma unroll
                    for (int n = 0; n < 2; ++n) acc[a][b][m][n] = (f32x4){0.f, 0.f, 0.f, 0.f};
        cur = nxt; cA = nA; cB = nB; ++ui;
        if constexpr (ALIGN_EPI) { if (wr == 1) PG8_BAR; }
    }
    PG8_WAIT_V(0);
    if constexpr (!ALIGN_EPI) { if (wr == 0) PG8_BAR; }
    PG8_BAR;
    if constexpr (Epi::AFTER_DRAIN) { E.fused(acc, cur, wr, wc, fr, fq, lds, wid, lane); S.done(cur); }
#undef PG8_SA
#undef PG8_SB
#undef PG8_STAGE
#undef PG8_LDA
#undef PG8_LDB
#undef PG8_MMA
#undef PG8_WAIT_V
#undef PG8_WAIT_L
#undef PG8_BAR
#undef PG8_SCHED
}
}

constexpr int NWAVES = 8;
constexpr int RING_OFF = 0, RING_BYTES = 131072;
constexpr int LDSCTL_OFF = RING_BYTES, MISC_OFF = LDSCTL_OFF + 320;
constexpr int LDS_BYTES = 147456;
static_assert(MISC_OFF + 128 <= LDS_BYTES, "LDS map");

#define GAS __attribute__((address_space(1)))
#define LAS __attribute__((address_space(3)))
typedef unsigned short bf16;
typedef unsigned v4u __attribute__((ext_vector_type(4)));
typedef unsigned v2u __attribute__((ext_vector_type(2)));
typedef float f32x4 __attribute__((ext_vector_type(4)));
typedef float f32x2 __attribute__((ext_vector_type(2)));
typedef short bf16x8 __attribute__((ext_vector_type(8)));
typedef short s16x4 __attribute__((ext_vector_type(4)));
typedef GAS unsigned gu32;
typedef GAS unsigned long long gu64;
#define RLX_AGENT __ATOMIC_RELAXED, __HIP_MEMORY_SCOPE_AGENT
#define LDS_WAIT() asm volatile("s_waitcnt lgkmcnt(0)" ::: "memory")
#define VM_WAIT() asm volatile("s_waitcnt vmcnt(0)" ::: "memory")
__device__ __forceinline__ unsigned f2bf(float f) { unsigned u = __builtin_bit_cast(unsigned, f); return (u + 0x7fffu + ((u >> 16) & 1u)) >> 16; }
__device__ __forceinline__ unsigned pk2(float lo, float hi) { return f2bf(lo) | (f2bf(hi) << 16); }
__device__ __forceinline__ float bflo(unsigned w) { return __uint_as_float(w << 16); }
__device__ __forceinline__ float bfhi(unsigned w) { return __uint_as_float(w & 0xffff0000u); }
__device__ __forceinline__ float bf1(unsigned short h) { return __uint_as_float((unsigned)h << 16); }

#define XB_TMO      128
#define XB_XCNT(j)  (256  + 64 * (j))
#define XB_XSUB(j)  (1280 + 64 * (j))
#define XB_XGEN(j)  (2304 + 64 * (j))
#define XB_TOP      3328
#define XB_TOPGEN   3392
#define XCD_BAR_WORDS 3456
#define XB_SPIN_CAP (1u << 18)

__device__ __forceinline__ unsigned xb_ld(unsigned* p)              { return __hip_atomic_load(p, __ATOMIC_RELAXED, __HIP_MEMORY_SCOPE_AGENT); }
__device__ __forceinline__ unsigned xb_add(unsigned* p, unsigned v) { return __hip_atomic_fetch_add(p, v, __ATOMIC_RELAXED, __HIP_MEMORY_SCOPE_AGENT); }
__device__ __forceinline__ unsigned xb_xcc_id() { return (unsigned)__builtin_amdgcn_s_getreg((3 << 11) | 20) & 0xFu; }
#define XB_SPIN(cond, bar) do { unsigned _sp = 0; while (cond) { __builtin_amdgcn_s_sleep(1); \
    if ((++_sp & 255u) == 0u) { if (xb_ld(&(bar)[XB_TMO])) break; if (_sp > XB_SPIN_CAP) { atomicAdd(&(bar)[XB_TMO], 1u); break; } } } } while (0)

struct XcdBarrier {
    unsigned* bar; unsigned x;
    volatile LAS unsigned* st;
};

__device__ __forceinline__ XcdBarrier xcd_barrier_post(unsigned* bar, volatile LAS unsigned* st) {
    XcdBarrier b; b.bar = bar; b.x = xb_xcc_id(); b.st = st;
    if (threadIdx.x == 0) (void)xb_add(&bar[XB_XCNT(b.x)], 1u);
    return b;
}
__device__ __forceinline__ void xcd_barrier_complete(unsigned* bar, unsigned x, unsigned& nloc, unsigned& nx) {
    const unsigned G = gridDim.x * gridDim.y * gridDim.z;
    unsigned sum, cnt, mine, sp = 0u;
    for (;;) {
        sum = 0u; cnt = 0u; mine = 0u;
#pragma unroll
        for (unsigned j = 0; j < 16; ++j) { const unsigned c = xb_ld(&bar[XB_XCNT(j)]); sum += c; cnt += (c > 0u) ? 1u : 0u; mine = (j == x) ? c : mine; }
        if (sum == G) break;
        __builtin_amdgcn_s_sleep(1);
        if ((++sp & 255u) == 0u) { if (xb_ld(&bar[XB_TMO])) break; if (sp > XB_SPIN_CAP) { atomicAdd(&bar[XB_TMO], 1u); break; } }
    }
    nloc = mine > 0u ? mine : 1u; nx = cnt > 0u ? cnt : 1u;
}

__device__ __forceinline__ void xcd_barrier(const XcdBarrier& b) {
    asm volatile("s_waitcnt vmcnt(0)" ::: "memory");
    __syncthreads();
    if (threadIdx.x == 0) {
        unsigned* bar = b.bar;
        __builtin_amdgcn_s_waitcnt(0);
        unsigned nloc = b.st[0], nx = b.st[1];
        if (nloc == 0u) { xcd_barrier_complete(bar, b.x, nloc, nx); b.st[0] = nloc; b.st[1] = nx; }
        const unsigned old = xb_add(&bar[XB_XSUB(b.x)], 1u);
        const unsigned gen = old / nloc;
        if (old + 1u == (gen + 1u) * nloc) {
            __builtin_amdgcn_fence(__ATOMIC_RELEASE, "agent");
            asm volatile("s_waitcnt vmcnt(0)" ::: "memory");
            const unsigned og = xb_add(&bar[XB_TOP], 1u);
            const unsigned tg = og / nx;
            if (og + 1u == (tg + 1u) * nx) xb_add(&bar[XB_TOPGEN], 1u);
            else XB_SPIN(xb_ld(&bar[XB_TOPGEN]) == tg, bar);
            __builtin_amdgcn_fence(__ATOMIC_ACQUIRE, "agent");
            xb_add(&bar[XB_XGEN(b.x)], 1u);
            asm volatile("s_waitcnt vmcnt(0)" ::: "memory");
        } else {
            XB_SPIN(xb_ld(&bar[XB_XGEN(b.x)]) == gen, bar);
            __builtin_amdgcn_fence(__ATOMIC_ACQUIRE, "agent");
            asm volatile("s_waitcnt vmcnt(0)" ::: "memory");
        }
    }
    __syncthreads();
}

__device__ __forceinline__ float wave_sum(float v) {
#pragma unroll
    for (int o = 1; o < 64; o <<= 1) v += __shfl_xor(v, o);
    return v;
}
__device__ __forceinline__ f32x4 up4(const v2u w) { return (f32x4){bflo(w.x), bfhi(w.x), bflo(w.y), bfhi(w.y)}; }
__device__ __forceinline__ v2u pk4(const f32x4 v) { v2u w; w.x = pk2(v[0], v[1]); w.y = pk2(v[2], v[3]); return w; }
typedef short v4i16_t __attribute__((ext_vector_type(4)));
__device__ __forceinline__ bf16x8 tr8(const LAS unsigned char* p0, const LAS unsigned char* p1) {
    const s16x4 lo = __builtin_bit_cast(s16x4, __builtin_amdgcn_ds_read_tr16_b64_v4i16((LAS v4i16_t*)p0));
    const s16x4 hi = __builtin_bit_cast(s16x4, __builtin_amdgcn_ds_read_tr16_b64_v4i16((LAS v4i16_t*)p1));
    return __builtin_shufflevector(lo, hi, 0, 1, 2, 3, 4, 5, 6, 7);
}
#define MFMA16(a, b, c) __builtin_amdgcn_mfma_f32_16x16x32_bf16((a), (b), (c), 0, 0, 0)

__device__ __forceinline__ void p0_tr_item(const float* W, int Nsrc, int K, int k0, int src_col0, bf16* WT, int dst_row0, float scale, LAS float* scr, int lane) {
#pragma unroll 8
    for (int i = 0; i < 32; ++i) { const int kk = 2 * i + (lane >> 5); scr[kk * 33 + (lane & 31)] = W[(size_t)(k0 + kk) * Nsrc + src_col0 + (lane & 31)]; }
    LDS_WAIT(); asm volatile("" ::: "memory");
    const int c = lane & 7;
#pragma unroll
    for (int j = 0; j < 4; ++j) { const int n = (lane >> 3) + 8 * j; const LAS float* s = scr + (8 * c) * 33 + n;
        v4u o; o.x = pk2(s[0 * 33] * scale, s[1 * 33] * scale); o.y = pk2(s[2 * 33] * scale, s[3 * 33] * scale); o.z = pk2(s[4 * 33] * scale, s[5 * 33] * scale); o.w = pk2(s[6 * 33] * scale, s[7 * 33] * scale);
        *(GAS v4u*)(WT + (size_t)(dst_row0 + n) * K + k0 + 8 * c) = o; }
    LDS_WAIT(); asm volatile("" ::: "memory");
}
__device__ __forceinline__ int swiglu_src(int nb) { const int n0 = nb * 32, tile = n0 >> 8, within = n0 & 255; return within < 128 ? 128 * tile + within : FF + 128 * tile + within - 128; }
__device__ __forceinline__ int win_src(int nb) { const int n0 = nb * 32, tile = n0 >> 8, within = n0 & 255;
    if (tile < 16) return n0; if (tile < 20) return n0 + 8;
    if (tile < 28) { const int j = tile - 20; return within < 128 ? 5128 + 128 * j + within : 6152 + 128 * j + within - 128; }
    return n0 + 8; }
__device__ __forceinline__ float win_scale(int nb) { const int tile = nb >> 3; return (tile >= 4 && tile < 8) ? 0.0625f : 1.0f; }

__device__ __forceinline__ void p0_prologue(LAS unsigned char* lds, const float* const* in, unsigned char* ws, int vcu, int G, int wave, int lane) {
    LAS float* scr = (LAS float*)(lds + RING_OFF + wave * 16384);
    const int gw = vcu * NWAVES + wave, NGW = G * NWAVES;
    constexpr int I_WI = (D / 64) * (2 * FF / 32), I_WO = (FF / 64) * (D / 32), I_WIN = (D / 64) * (NZ / 32), I_SQ = (D / 64) * (D / 32), I_PP = (PD / 64) * (D / 32);
    constexpr int NITEMS = 2 * I_WI + 2 * I_WO + I_WIN + 4 * I_SQ + I_PP;
    for (int it = gw; it < NITEMS; it += NGW) {
        int r = it;
        if (r < I_WI) { const int nblk = 2 * FF / 32, kb = r / nblk, nb = r % nblk; p0_tr_item(in[16], 2 * FF, D, 64 * kb, swiglu_src(nb), (bf16*)(ws + WS_WI1), 32 * nb, 1.f, scr, lane); continue; } r -= I_WI;
        if (r < I_WIN) { const int nblk = NZ / 32, kb = r / nblk, nb = r % nblk; p0_tr_item(in[8], NIN, D, 64 * kb, win_src(nb), (bf16*)(ws + WS_WIN), 32 * nb, win_scale(nb), scr, lane); continue; } r -= I_WIN;
        if (r < I_WO) { const int nblk = D / 32, kb = r / nblk, nb = r % nblk; p0_tr_item(in[17], D, FF, 64 * kb, 32 * nb, (bf16*)(ws + WS_WO1), 32 * nb, 1.f, scr, lane); continue; } r -= I_WO;
        if (r < 4 * I_SQ) { const int mi = r / I_SQ, rr = r % I_SQ, nblk = D / 32, kb = rr / nblk, nb = rr % nblk;
            const float* W = mi == 0 ? in[11] : mi == 1 ? in[12] : mi == 2 ? in[15] : in[20];
            bf16* WT = (bf16*)(ws + (mi == 0 ? WS_WA : mi == 1 ? WS_WB : mi == 2 ? WS_WMIX : WS_WPG));
            p0_tr_item(W, D, D, 64 * kb, 32 * nb, WT, 32 * nb, 1.f, scr, lane); continue; } r -= 4 * I_SQ;
        if (r < I_PP) { const int nblk = D / 32, kb = r / nblk, nb = r % nblk; p0_tr_item(in[21], D, PD, 64 * kb, 32 * nb, (bf16*)(ws + WS_WPP), 32 * nb, 1.f, scr, lane); continue; } r -= I_PP;
        if (r < I_WI) { const int nblk = 2 * FF / 32, kb = r / nblk, nb = r % nblk; p0_tr_item(in[18], 2 * FF, D, 64 * kb, swiglu_src(nb), (bf16*)(ws + WS_WI2), 32 * nb, 1.f, scr, lane); continue; } r -= I_WI;
        { const int nblk = D / 32, kb = r / nblk, nb = r % nblk; p0_tr_item(in[19], D, FF, 64 * kb, 32 * nb, (bf16*)(ws + WS_WO2), 32 * nb, 1.f, scr, lane); }
    }
    bf16* XB = (bf16*)(ws + WS_SLAB0 + SL_X * SLABB); bf16* PB = (bf16*)(ws + WS_PB);
    for (int m = gw; m < M_PAD; m += NGW) {
        GAS v2u* xo = (GAS v2u*)(XB + (size_t)m * D) + lane; GAS v2u* po = (GAS v2u*)(PB + (size_t)m * PD) + lane;
        if (m < M_REAL) {
            const float* xr = m < T_PROMPT ? in[0] + (size_t)m * D : in[1] + (size_t)(m - T_PROMPT) * D;
            const float* pr = m < T_PROMPT ? in[2] + (size_t)m * PD : in[3] + (size_t)(m - T_PROMPT) * PD;
#pragma unroll
            for (int j = 0; j < 4; ++j) { const f32x4 v = ((const GAS f32x4*)xr)[64 * j + lane]; xo[64 * j] = pk4(v); }
            { const f32x4 v = ((const GAS f32x4*)pr)[lane]; po[0] = pk4(v); }
        } else {
#pragma unroll
            for (int j = 0; j < 4; ++j) xo[64 * j] = (v2u){0u, 0u};
            po[0] = (v2u){0u, 0u};
        }
    }
    float* bperm = (float*)(ws + WS_BPERM); float* wg = (float*)(ws + WS_WG); float* bg = (float*)(ws + WS_BG);
    for (int idx = gw * 64 + lane; idx < NZ + 8 * D + 8; idx += NGW * 64) {
        if (idx < NZ) { const int nb = idx >> 5; bperm[idx] = in[9][win_src(nb) + (idx & 31)] * win_scale(nb); }
        else if (idx < NZ + 8 * D) { const int r = idx - NZ, j = r >> 10, k = r & 1023; wg[r] = in[8][(size_t)k * NIN + I0_COL + j]; }
        else { const int j = idx - NZ - 8 * D; bg[j] = in[9][I0_COL + j]; }
    }
}

__device__ __forceinline__ float log_sigmoid_f(float z) { return z >= 0.f ? -log1pf(expf(-z)) : z - log1pf(expf(z)); }
__device__ __forceinline__ void ln_phase(int gw, int NGW, int lane, const float* R, const float* g, const float* b, bf16* outb, float* outf_p, float* outf_s, const float* wg, const float* bg, float* gates) {
    for (int m = gw; m < M_REAL; m += NGW) {
        const GAS f32x4* xr = (const GAS f32x4*)(R + (size_t)m * D) + lane;
        f32x4 v[4]; float s = 0.f;
#pragma unroll
        for (int j = 0; j < 4; ++j) { v[j] = xr[64 * j]; s += (v[j][0] + v[j][1]) + (v[j][2] + v[j][3]); }
        const float mean = wave_sum(s) * (1.f / D); float s2 = 0.f;
#pragma unroll
        for (int j = 0; j < 4; ++j) { v[j] = v[j] - mean; s2 += (v[j][0] * v[j][0] + v[j][1] * v[j][1]) + (v[j][2] * v[j][2] + v[j][3] * v[j][3]); }
        const float rstd = 1.f / sqrtf(wave_sum(s2) * (1.f / D) + LN_EPS);
#pragma unroll
        for (int j = 0; j < 4; ++j) { const f32x4 gv = ((const GAS f32x4*)g)[64 * j + lane], bv = ((const GAS f32x4*)b)[64 * j + lane]; v[j] = v[j] * rstd * gv + bv; }
        if (outb) { GAS v2u* o8 = (GAS v2u*)(outb + (size_t)m * D) + lane;
#pragma unroll
            for (int j = 0; j < 4; ++j) o8[64 * j] = pk4(v[j]); }
        if (outf_p) { GAS f32x4* o = (GAS f32x4*)(m < T_PROMPT ? outf_p + (size_t)m * D : outf_s + (size_t)(m - T_PROMPT) * D) + lane;
#pragma unroll
            for (int j = 0; j < 4; ++j) o[64 * j] = v[j]; }
        if (gates) {
            float mine = 0.f;
#pragma unroll
            for (int h8 = 0; h8 < 8; ++h8) { float p = 0.f;
#pragma unroll
                for (int j = 0; j < 4; ++j) { const f32x4 w = ((const GAS f32x4*)(wg + h8 * D))[64 * j + lane]; p += (v[j][0] * w[0] + v[j][1] * w[1]) + (v[j][2] * w[2] + v[j][3] * w[3]); }
                p = wave_sum(p); if (lane == h8) mine = p; }
            if (lane < 8) { float z = mine + bg[lane]; if (lane >= 4) z = log_sigmoid_f(z); gates[(size_t)m * 8 + lane] = z; }
        }
    }
}

constexpr int ML_RSQ = 544, ML_RSV = 272, ML_RSS = 144;
constexpr int ML_Q = 0, ML_K = 64 * ML_RSQ, ML_V = 2 * 64 * ML_RSQ, ML_S = ML_V + 64 * ML_RSV, ML_ARR = ML_S + 64 * ML_RSS;
constexpr int ML_BYTES = ML_ARR + 6 * 256 + 2048;
static_assert(ML_BYTES <= RING_BYTES, "mLSTM LDS");

__device__ __forceinline__ void mlstm_prompt(LAS unsigned char* lds, int wgp, const bf16* Qb, const bf16* Kb, const bf16* Vb, const float* gates, float* hraw, float* out) {
    const int tid = threadIdx.x, lane = tid & 63, wid = __builtin_amdgcn_readfirstlane(tid >> 6);
    const int b = wgp >> 3, h = (wgp >> 1) & 3, half = wgp & 1, l15 = lane & 15, g4 = lane >> 4, tq = l15 >> 2, tp = l15 & 3;
    LAS float* arr = (LAS float*)(lds + ML_ARR);
    LAS float *aA = arr, *MA = arr + 64, *wiA = arr + 128, *enA = arr + 192, *scA = arr + 256, *rdA = arr + 320, *nA = arr + 384;
    nA[tid] = 0.f;
    f32x4 acc[16];
#pragma unroll
    for (int i = 0; i < 16; ++i) acc[i] = (f32x4){0.f, 0.f, 0.f, 0.f};
    float m = 0.f;
    const size_t rowbase = (size_t)b * SEQ;
    const size_t colq = (size_t)h * HD, colv = (size_t)h * HD + half * 128;
    v4u pq[4], pk[4], pv[2]; float pli, plf;
#define ML_LOADC(cc) do { const size_t r0_ = rowbase + 64 * (size_t)(cc); \
        _Pragma("unroll") for (int i_ = 0; i_ < 4; ++i_) { const int p_ = tid + 512 * i_, t_ = p_ >> 5, c_ = p_ & 31; const size_t o_ = ((r0_ + t_) * D + colq) * 2 + c_ * 16; \
            pq[i_] = *(const GAS v4u*)((const GAS char*)Qb + o_); pk[i_] = *(const GAS v4u*)((const GAS char*)Kb + o_); } \
        _Pragma("unroll") for (int i_ = 0; i_ < 2; ++i_) { const int p_ = tid + 512 * i_, t_ = p_ >> 4, c_ = p_ & 15; pv[i_] = *(const GAS v4u*)((const GAS char*)Vb + ((r0_ + t_) * D + colv) * 2 + c_ * 16); } \
        pli = gates[(r0_ + lane) * 8 + h]; plf = gates[(r0_ + lane) * 8 + 4 + h]; } while (0)
    ML_LOADC(0);
    for (int c = 0; c < NCHUNK; ++c) {
        const size_t r0 = rowbase + 64 * (size_t)c;
        __syncthreads();
#pragma unroll
        for (int i = 0; i < 4; ++i) { const int p = tid + 512 * i, t = p >> 5, c16 = p & 31; *(LAS v4u*)(lds + ML_Q + t * ML_RSQ + c16 * 16) = pq[i]; *(LAS v4u*)(lds + ML_K + t * ML_RSQ + c16 * 16) = pk[i]; }
#pragma unroll
        for (int i = 0; i < 2; ++i) { const int p = tid + 512 * i, t = p >> 4, c16 = p & 15; *(LAS v4u*)(lds + ML_V + t * ML_RSV + c16 * 16) = pv[i]; }
        const float li = pli, lf = plf;
        if (c + 1 < NCHUNK) ML_LOADC(c + 1);
        float bcs = lf;
#pragma unroll
        for (int off = 1; off < 64; off <<= 1) { const float o = __shfl_up(bcs, off); if (lane >= off) bcs += o; }
        const float a = li - bcs; float amax = a;
#pragma unroll
        for (int off = 1; off < 64; off <<= 1) { const float o = __shfl_up(amax, off); if (lane >= off) amax = fmaxf(amax, o); }
        const float Mv = fmaxf(m, amax);
        const float M63 = __shfl(Mv, 63), b63 = __shfl(bcs, 63);
        const float wc = __expf(m - M63), m_new = b63 + M63;
        if (wid == 0) { aA[lane] = a; MA[lane] = Mv; wiA[lane] = __expf(m - Mv); enA[lane] = __expf(-bcs - Mv); scA[lane] = __expf(a - M63); }
        __syncthreads();
        {
            const int tt = wid >> 1, tsb = 2 * (wid & 1);
#pragma unroll
            for (int j = 0; j < 2; ++j) {
                const int ts = tsb + j; f32x4 gacc = (f32x4){0.f, 0.f, 0.f, 0.f};
                if (ts <= tt) {
#pragma unroll
                    for (int ks = 0; ks < 8; ++ks) {
                        const bf16x8 A = *(const LAS bf16x8*)(lds + ML_Q + (16 * tt + l15) * ML_RSQ + (32 * ks + 8 * g4) * 2);
                        const bf16x8 B = *(const LAS bf16x8*)(lds + ML_K + (16 * ts + l15) * ML_RSQ + (32 * ks + 8 * g4) * 2);
                        gacc = MFMA16(A, B, gacc);
                    }
                }
                const int s = 16 * ts + l15; const float as = aA[s]; const f32x4 M4 = *(const LAS f32x4*)(MA + 16 * tt + 4 * g4);
#pragma unroll
                for (int r = 0; r < 4; ++r) { const int t = 16 * tt + 4 * g4 + r; const float v = (s <= t) ? gacc[r] * __expf(as - M4[r]) : 0.f;
                    *(LAS unsigned short*)(lds + ML_S + t * ML_RSS + s * 2) = (unsigned short)f2bf(v); }
            }
        }
        __syncthreads();
        const int cur = c & 1;
        {
            const int t = tid >> 3, part = tid & 7; float qn = 0.f;
#pragma unroll
            for (int i = 0; i < 4; ++i) { const v4u w = *(const LAS v4u*)(lds + ML_Q + t * ML_RSQ + part * 64 + i * 16);
                const f32x4 n0 = *(const LAS f32x4*)(nA + cur * 256 + part * 32 + i * 8), n1 = *(const LAS f32x4*)(nA + cur * 256 + part * 32 + i * 8 + 4);
                qn += (bflo(w.x) * n0[0] + bfhi(w.x) * n0[1]) + (bflo(w.y) * n0[2] + bfhi(w.y) * n0[3]) + (bflo(w.z) * n1[0] + bfhi(w.z) * n1[1]) + (bflo(w.w) * n1[2] + bfhi(w.w) * n1[3]); }
            const v4u sw = *(const LAS v4u*)(lds + ML_S + t * ML_RSS + part * 16);
            const float ss = ((bflo(sw.x) + bfhi(sw.x)) + (bflo(sw.y) + bfhi(sw.y))) + ((bflo(sw.z) + bfhi(sw.z)) + (bflo(sw.w) + bfhi(sw.w)));
            float v = wiA[t] * qn + ss; v += __shfl_xor(v, 1); v += __shfl_xor(v, 2); v += __shfl_xor(v, 4);
            if (part == 0) rdA[t] = 1.0f / fmaxf(fabsf(v), enA[t]);
        }
        if (tid < 256) {
            const int d = tid; float accn = wc * nA[cur * 256 + d];
#pragma unroll 4
            for (int s4 = 0; s4 < 16; ++s4) { const f32x4 sc4 = *(const LAS f32x4*)(scA + 4 * s4);
#pragma unroll
                for (int r = 0; r < 4; ++r) accn += sc4[r] * bf1(*(const LAS unsigned short*)(lds + ML_K + (4 * s4 + r) * ML_RSQ + d * 2)); }
            nA[(cur ^ 1) * 256 + d] = accn;
        }
        f32x4 accP[4];
#pragma unroll
        for (int tt = 0; tt < 4; ++tt) accP[tt] = (f32x4){0.f, 0.f, 0.f, 0.f};
#pragma unroll
        for (int ds = 0; ds < 8; ++ds) {
            const f32x4 ca = acc[2 * ds], cb = acc[2 * ds + 1];
            v4u bw; bw.x = pk2(ca[0], ca[1]); bw.y = pk2(ca[2], ca[3]); bw.z = pk2(cb[0], cb[1]); bw.w = pk2(cb[2], cb[3]);
            const bf16x8 Bc = __builtin_bit_cast(bf16x8, bw);
#pragma unroll
            for (int tt = 0; tt < 4; ++tt) {
                const LAS unsigned char* qp = lds + ML_Q + (16 * tt + l15) * ML_RSQ + (32 * ds + 4 * g4) * 2;
                const v2u lo = *(const LAS v2u*)qp, hi = *(const LAS v2u*)(qp + 32);
                const bf16x8 A = __builtin_bit_cast(bf16x8, (v4u){lo.x, lo.y, hi.x, hi.y});
                accP[tt] = MFMA16(A, Bc, accP[tt]);
            }
        }
#pragma unroll
        for (int tt = 0; tt < 4; ++tt) { const f32x4 w4 = *(const LAS f32x4*)(wiA + 16 * tt + 4 * g4); accP[tt] = accP[tt] * w4; }
        bf16x8 Bv[2];
#pragma unroll
        for (int ks = 0; ks < 2; ++ks) { const LAS unsigned char* vp = lds + ML_V + (32 * ks + 8 * g4 + tq) * ML_RSV + (16 * wid + 4 * tp) * 2; Bv[ks] = tr8(vp, vp + 4 * ML_RSV); }
#pragma unroll
        for (int tt = 0; tt < 4; ++tt)
#pragma unroll
            for (int ks = 0; ks < 2; ++ks)
                if (ks == 0 || tt >= 2) { const bf16x8 A = *(const LAS bf16x8*)(lds + ML_S + (16 * tt + l15) * ML_RSS + (32 * ks + 8 * g4) * 2); accP[tt] = MFMA16(A, Bv[ks], accP[tt]); }
        __syncthreads();
#pragma unroll
        for (int tt = 0; tt < 4; ++tt) { const f32x4 r4 = *(const LAS f32x4*)(rdA + 16 * tt + 4 * g4);
#pragma unroll
            for (int r = 0; r < 4; ++r) hraw[(r0 + 16 * tt + 4 * g4 + r) * D + colv + 16 * wid + l15] = accP[tt][r] * r4[r]; }
        bf16x8 Bs[2];
#pragma unroll
        for (int ks = 0; ks < 2; ++ks) { const f32x4 s0 = *(const LAS f32x4*)(scA + 32 * ks + 8 * g4), s1 = *(const LAS f32x4*)(scA + 32 * ks + 8 * g4 + 4);
            const v4u w = __builtin_bit_cast(v4u, Bv[ks]); v4u o;
            o.x = pk2(bflo(w.x) * s0[0], bfhi(w.x) * s0[1]); o.y = pk2(bflo(w.y) * s0[2], bfhi(w.y) * s0[3]); o.z = pk2(bflo(w.z) * s1[0], bfhi(w.z) * s1[1]); o.w = pk2(bflo(w.w) * s1[2], bfhi(w.w) * s1[3]);
            Bs[ks] = __builtin_bit_cast(bf16x8, o); }
#pragma unroll
        for (int dt = 0; dt < 16; ++dt) {
            acc[dt] = acc[dt] * wc;
#pragma unroll
            for (int ks = 0; ks < 2; ++ks) { const LAS unsigned char* kp = lds + ML_K + (32 * ks + 8 * g4 + tq) * ML_RSQ + (16 * dt + 4 * tp) * 2; const bf16x8 A = tr8(kp, kp + 4 * ML_RSQ); acc[dt] = MFMA16(A, Bs[ks], acc[dt]); }
        }
        m = m_new;
    }
#undef ML_LOADC
    __syncthreads();
    const size_t bh = (size_t)b * NH + h;
#pragma unroll
    for (int dt = 0; dt < 16; ++dt)
#pragma unroll
        for (int r = 0; r < 4; ++r) out[O_CP + (bh * HD + 16 * dt + 4 * g4 + r) * HD + half * 128 + 16 * wid + l15] = acc[dt][r];
    if (half == 0) { if (tid < 256) out[O_NP + bh * HD + tid] = nA[(NCHUNK & 1) * 256 + tid]; if (tid == 0) out[O_MP + bh] = m; }
    __syncthreads();
}

__device__ __forceinline__ void mlstm_sample_item(LAS unsigned char* lds, int item, const bf16* Qb, const bf16* Kb, const bf16* Vb, const float* gates, const float* stC, const float* stn, const float* stm, float* hraw, float* out) {
    const int tid = threadIdx.x, lane = tid & 63, wid = __builtin_amdgcn_readfirstlane(tid >> 6);
    const int bsm = item >> 2, h = item & 3; const size_t row = (size_t)T_PROMPT + bsm, bh = (size_t)item;
    LAS float* qA = (LAS float*)lds; LAS float* kA = qA + 256; LAS float* vA = kA + 256; LAS float* red = vA + 256; LAS float* sc = red + 2048;
    __syncthreads();
    float pqk = 0.f, pqn = 0.f, n0 = 0.f, kf = 0.f;
    if (tid < 256) { const size_t o = row * D + h * HD + tid; const float qf = bf1(Qb[o]); kf = bf1(Kb[o]); const float vf = bf1(Vb[o]); n0 = stn[bh * HD + tid];
        qA[tid] = qf; kA[tid] = kf; vA[tid] = vf; pqk = qf * kf; pqn = qf * n0; }
    pqk = wave_sum(pqk); pqn = wave_sum(pqn);
    if (lane == 0 && wid < 4) { sc[wid] = pqk; sc[4 + wid] = pqn; }
    __syncthreads();
    const float qk = (sc[0] + sc[1]) + (sc[2] + sc[3]), qn = (sc[4] + sc[5]) + (sc[6] + sc[7]);
    const float li = gates[row * 8 + h], lf = gates[row * 8 + 4 + h], m0 = stm[bh];
    const float mrow = fmaxf(lf + m0, li), wi = __expf(lf + m0 - mrow), sk = __expf(li - mrow);
    const float s = qk * sk, den = wi * qn + s, rden = 1.0f / fmaxf(fabsf(den), __expf(-mrow));
    if (tid < 256) out[O_NS + bh * HD + tid] = wi * n0 + kf * sk;
    if (tid == 0) out[O_MS + bh] = mrow;
    const f32x4 v4 = *(const LAS f32x4*)(vA + 4 * lane);
    const float* Cin = stC + bh * (size_t)(HD * HD); float* Cout = out + O_CS + bh * (size_t)(HD * HD);
    f32x4 qc = (f32x4){0.f, 0.f, 0.f, 0.f};
#pragma unroll 8
    for (int i = 0; i < 32; ++i) { const int d = wid * 32 + i;
        const f32x4 cv = __builtin_nontemporal_load((const f32x4*)(Cin + (size_t)d * HD) + lane);
        const float qd = qA[d], kd = kA[d] * sk;
        qc = qc + cv * qd; const f32x4 cn = cv * wi + v4 * kd;
        __builtin_nontemporal_store(cn, (f32x4*)(Cout + (size_t)d * HD) + lane); }
    *(LAS f32x4*)(red + wid * 256 + 4 * lane) = qc;
    __syncthreads();
    if (tid < 256) { float t = 0.f;
#pragma unroll
        for (int w = 0; w < 8; ++w) t += red[w * 256 + tid];
        hraw[row * D + h * HD + tid] = (wi * t + s * vA[tid]) * rden; }
}

__device__ __forceinline__ void elementwise_phase(int gw, int NGW, int lane, const float* hraw, const bf16* Ob, const bf16* BBb, const bf16* PREb, const float* gnorm, const float* convw, const float* convb, const float* stconv,
                                                  bf16* AA, bf16* AB, float* out) {
    for (int m = gw; m < M_REAL; m += NGW) {
        const bool prompt = m < T_PROMPT; const int t = prompt ? (m & (SEQ - 1)) : 0, bs = m - T_PROMPT;
#pragma unroll
        for (int j = 0; j < 4; ++j) {
            const int c = 256 * j + 4 * lane; const size_t off = (size_t)m * D + c;
            const f32x4 hv = *(const GAS f32x4*)(hraw + off);
            const float mean = wave_sum((hv[0] + hv[1]) + (hv[2] + hv[3])) * (1.f / HD);
            const f32x4 dv = hv - mean;
            const float var = wave_sum((dv[0] * dv[0] + dv[1] * dv[1]) + (dv[2] * dv[2] + dv[3] * dv[3])) * (1.f / HD);
            const float rstd = 1.f / sqrtf(var + LN_EPS);
            const f32x4 gn = *(const GAS f32x4*)(gnorm + c), so = up4(*(const GAS v2u*)(Ob + off));
            *(GAS v2u*)(AA + off) = pk4(dv * rstd * gn * so);
            const f32x4 p0 = up4(*(const GAS v2u*)(PREb + off)); f32x4 p1 = (f32x4){0.f, 0.f, 0.f, 0.f}, p2 = p1;
            if (prompt) { if (t >= 1) p1 = up4(*(const GAS v2u*)(PREb + off - D)); if (t >= 2) p2 = up4(*(const GAS v2u*)(PREb + off - 2 * D)); }
            else { p1 = *(const GAS f32x4*)(stconv + ((size_t)bs * 2 + 1) * D + c); p2 = *(const GAS f32x4*)(stconv + ((size_t)bs * 2) * D + c); }
            const f32x4 w0 = *(const GAS f32x4*)(convw + c), w1 = *(const GAS f32x4*)(convw + D + c), w2 = *(const GAS f32x4*)(convw + 2 * D + c), cb = *(const GAS f32x4*)(convb + c);
            const f32x4 y = cb + w0 * p2 + w1 * p1 + w2 * p0;
            *(GAS v2u*)(AB + off) = pk4(up4(*(const GAS v2u*)(BBb + off)) * y);
            if (prompt) { if (t >= SEQ - 2) *(GAS f32x4*)(out + O_CVP + ((size_t)(m >> 11) * 2 + (t - (SEQ - 2))) * D + c) = p0; }
            else { *(GAS f32x4*)(out + O_CVS + ((size_t)bs * 2) * D + c) = p1; *(GAS f32x4*)(out + O_CVS + ((size_t)bs * 2 + 1) * D + c) = p0; }
        }
    }
}

#ifndef MK_PER_PHASE
#define MK_PER_PHASE 0
#endif
constexpr int N_PHASES = 15;
struct Args { const float* in[24]; float* out; unsigned char* ws; int ph_lo, ph_hi; };
typedef pg8::bf16_t pbf;

__global__ void __launch_bounds__(NWAVES * 64, 2) fwd_kernel(Args args) {
    extern __shared__ __attribute__((aligned(16))) unsigned char lds_raw[];
    LAS unsigned char* lds = (LAS unsigned char*)lds_raw;
    volatile LAS unsigned* MISC = (volatile LAS unsigned*)(lds + MISC_OFF);
    const int tid = threadIdx.x, lane = tid & 63, wave = __builtin_amdgcn_readfirstlane(tid >> 6);
    const int G = gridDim.x; const int bx = blockIdx.x; const int vcu = (G % 8 == 0) ? (bx % 8) * (G / 8) + bx / 8 : bx;
    unsigned char* ws = args.ws; gu32* ctl = (gu32*)(ws + WS_CTL);
    for (int u = tid; u < (LDS_BYTES - LDSCTL_OFF) / 4; u += NWAVES * 64) ((LAS unsigned*)(lds + LDSCTL_OFF))[u] = 0u;
    __syncthreads();
    XcdBarrier bar; bar.bar = (unsigned*)(ctl + CW_BAR); bar.x = 0; bar.st = nullptr;
    if (!MK_PER_PHASE) bar = xcd_barrier_post((unsigned*)(ctl + CW_BAR), MISC + 8);
#define GRID_BAR() do { if (!MK_PER_PHASE) xcd_barrier(bar); } while (0)
    const int lo = args.ph_lo, hi = args.ph_hi;
#define IN(k) (lo <= (k) && (k) < hi)
#define BOTH(k) (IN(k) && IN((k) + 1))
    const int gw = vcu * NWAVES + wave, NGW = G * NWAVES;
    float* out = args.out;
    unsigned char* slabs = ws + WS_SLAB0;
#define SLAB(i) ((pbf*)(slabs + (size_t)(i) * SLABB))
    float* Rbuf = (float*)(slabs + (size_t)SL_R * SLABB);
    float* hraw = (float*)(slabs + (size_t)SL_HRAW * SLABB);
    float* gates = (float*)(ws + WS_GATES);
    const float* ln_g = args.in[22]; const float* ln_b = args.in[23];
    typedef pg8::EpiBf EB; typedef pg8::EpiF EF;
#define RUN_GEMM(EpiT, A_, Bt_, N_, K_, E_) do { pg8::Gemm g_{(const pbf*)(A_), (const pbf*)(Bt_), M_PAD, (N_), (K_)}; pg8::StaticOrder S_; S_.init(M_PAD, (N_), G, (int)blockIdx.x); \
        pg8::gemm_phase<EpiT, pg8::StaticOrder, true, true>(lds + RING_OFF, g_, S_, (E_)); } while (0)

    if (IN(0)) { p0_prologue(lds, args.in, ws, vcu, G, wave, lane); if (BOTH(0)) GRID_BAR(); }
    if (IN(1)) { EB E{pg8::EB_SWIGLU, SLAB(SL_H), FF, nullptr, nullptr, nullptr, slabs}; RUN_GEMM(EB, SLAB(SL_X), ws + WS_WI1, 2 * FF, D, E); if (BOTH(1)) GRID_BAR(); }
    if (IN(2)) { EF E{pg8::EF_X, Rbuf, args.in[0], args.in[1], nullptr, nullptr, 0.5f}; RUN_GEMM(EF, SLAB(SL_H), ws + WS_WO1, D, FF, E); if (BOTH(2)) GRID_BAR(); }
    if (IN(3)) { ln_phase(gw, NGW, lane, Rbuf, ln_g, ln_b, SLAB(SL_X), nullptr, nullptr, (const float*)(ws + WS_WG), (const float*)(ws + WS_BG), gates); if (BOTH(3)) GRID_BAR(); }
    if (IN(4)) { EB E{pg8::EB_WIN, nullptr, D, nullptr, nullptr, (const float*)(ws + WS_BPERM), slabs}; RUN_GEMM(EB, SLAB(SL_X), ws + WS_WIN, NZ, D, E); if (BOTH(4)) GRID_BAR(); }
    if (IN(5)) {
        if (vcu < 64 && G > 64) mlstm_prompt(lds, vcu, SLAB(SL_Q), SLAB(SL_K), SLAB(SL_V), gates, hraw, out);
        else if (G > 64) { for (int it = vcu - 64; it < T_SAMPLE * NH; it += G - 64) mlstm_sample_item(lds, it, SLAB(SL_Q), SLAB(SL_K), SLAB(SL_V), gates, args.in[4], args.in[5], args.in[6], hraw, out); }
        if (BOTH(5)) GRID_BAR();
    }
    if (IN(6)) { elementwise_phase(gw, NGW, lane, hraw, SLAB(SL_O), SLAB(SL_BB), SLAB(SL_PRE), args.in[10], args.in[13], args.in[14], args.in[7], SLAB(SL_AA), SLAB(SL_AB), out); if (BOTH(6)) GRID_BAR(); }
    if (IN(7)) {
        { EB E{pg8::EB_GATE_A, SLAB(SL_TA), D, SLAB(SL_SGA), nullptr, nullptr, slabs}; RUN_GEMM(EB, SLAB(SL_AA), ws + WS_WA, D, D, E); }
        { EB E{pg8::EB_GATE_B, SLAB(SL_MIX), D, SLAB(SL_SGB), SLAB(SL_TA), nullptr, slabs}; RUN_GEMM(EB, SLAB(SL_AB), ws + WS_WB, D, D, E); }
        if (BOTH(7)) GRID_BAR();
    }
    if (IN(8)) { EF E{pg8::EF_BF, Rbuf, nullptr, nullptr, SLAB(SL_X), nullptr, 1.0f}; RUN_GEMM(EF, SLAB(SL_MIX), ws + WS_WMIX, D, D, E); if (BOTH(8)) GRID_BAR(); }
    if (IN(9)) { ln_phase(gw, NGW, lane, Rbuf, ln_g + D, ln_b + D, SLAB(SL_X2), nullptr, nullptr, nullptr, nullptr, nullptr); if (BOTH(9)) GRID_BAR(); }
    if (IN(10)) { EB E{pg8::EB_SWIGLU, SLAB(SL_H), FF, nullptr, nullptr, nullptr, slabs}; RUN_GEMM(EB, SLAB(SL_X2), ws + WS_WI2, 2 * FF, D, E); if (BOTH(10)) GRID_BAR(); }
    if (IN(11)) { EF E{pg8::EF_BF, Rbuf, nullptr, nullptr, SLAB(SL_X2), nullptr, 0.5f}; RUN_GEMM(EF, SLAB(SL_H), ws + WS_WO2, D, FF, E); if (BOTH(11)) GRID_BAR(); }
    if (IN(12)) { ln_phase(gw, NGW, lane, Rbuf, ln_g + 2 * D, ln_b + 2 * D, SLAB(SL_X), nullptr, nullptr, nullptr, nullptr, nullptr); if (BOTH(12)) GRID_BAR(); }
    if (IN(13)) {
        { EF E{pg8::EF_PLAINBF, (float*)SLAB(SL_PP), nullptr, nullptr, nullptr, nullptr, 1.0f}; RUN_GEMM(EF, ws + WS_PB, ws + WS_WPP, D, PD, E); }
        { EF E{pg8::EF_PG, Rbuf, nullptr, nullptr, SLAB(SL_X), SLAB(SL_PP), 1.0f}; RUN_GEMM(EF, SLAB(SL_X), ws + WS_WPG, D, D, E); }
        if (BOTH(13)) GRID_BAR();
    }
    if (IN(14)) { ln_phase(gw, NGW, lane, Rbuf, ln_g + 3 * D, ln_b + 3 * D, nullptr, out + O_YP, out + O_YS, nullptr, nullptr, nullptr); }
#undef IN
#undef BOTH
#undef SLAB
#undef RUN_GEMM
#undef GRID_BAR
}

extern "C" void kernel_launch(void* const* d_in, const int* in_sizes, int n_in, void* d_out, int out_size, void* d_ws, size_t ws_size, hipStream_t stream) {
    static int grid = 0;
    if (grid == 0) {
        if (n_in != 24 || (size_t)out_size != O_TOTAL || ws_size < WS_END) { fprintf(stderr, "kernel_launch: unexpected problem (n_in %d, out %d, ws %zu; need 24, %zu, >= %zu); nothing launched\n", n_in, out_size, ws_size, (size_t)O_TOTAL, (size_t)WS_END); grid = -1; return; }
        int dev = 0, cus = 0, per_cu = 0;
        if (hipGetDevice(&dev) != hipSuccess || hipDeviceGetAttribute(&cus, hipDeviceAttributeMultiprocessorCount, dev) != hipSuccess) { fprintf(stderr, "kernel_launch: device query failed\n"); grid = -1; return; }
        if (hipFuncSetAttribute((const void*)fwd_kernel, hipFuncAttributeMaxDynamicSharedMemorySize, LDS_BYTES) != hipSuccess) { fprintf(stderr, "kernel_launch: hipFuncSetAttribute failed\n"); grid = -1; return; }
        if (hipOccupancyMaxActiveBlocksPerMultiprocessor(&per_cu, (const void*)fwd_kernel, NWAVES * 64, LDS_BYTES) != hipSuccess || per_cu < 1)
            fprintf(stderr, "kernel_launch: note: occupancy query reports %d workgroups per CU\n", per_cu);
        (void)hipGetLastError();
        grid = cus;
    }
    if (grid < 0) return;
    if (hipMemsetAsync((char*)d_ws + WS_CTL, 0, CTL_ZERO_BYTES, stream) != hipSuccess) { fprintf(stderr, "kernel_launch: hipMemsetAsync failed\n"); return; }
    Args a{};
    for (int i = 0; i < 24; ++i) a.in[i] = (const float*)d_in[i];
    a.out = (float*)d_out; a.ws = (unsigned char*)d_ws;
#if MK_PER_PHASE
    for (int p = 0; p < N_PHASES; ++p) { a.ph_lo = p; a.ph_hi = p + 1; hipLaunchKernelGGL(fwd_kernel, dim3(grid), dim3(NWAVES * 64), LDS_BYTES, stream, a); }
#else
    a.ph_lo = 0; a.ph_hi = N_PHASES;
    hipLaunchKernelGGL(fwd_kernel, dim3(grid), dim3(NWAVES * 64), LDS_BYTES, stream, a);
#endif
    const hipError_t le = hipPeekAtLastError();
    if (le != hipSuccess) fprintf(stderr, "kernel_launch: launch failed: %s\n", hipGetErrorName(le));
}
```
